# Optimizing an MI355X kernel written in HIP

```python
import math
import jax, jax.numpy as jnp
from jax import lax
import numpy as np

D_MODEL = 1024
BATCH = 16
SEQ = 2048
DEPTH = 2

HEAD_DIM = 64
SB_HEADS = 8
DIFF_HEADS = 4
DIFF_V_DIM = 2 * HEAD_DIM
SB_WIDTH = SB_HEADS * HEAD_DIM
DIFF_QK_WIDTH = DIFF_HEADS * 2 * HEAD_DIM
DIFF_V_WIDTH = DIFF_HEADS * DIFF_V_DIM
MIX_WIDTH = SB_WIDTH + DIFF_V_WIDTH
IN_WIDTH = 3 * SB_WIDTH + 2 * DIFF_QK_WIDTH + DIFF_V_WIDTH
CONV_WIDTH = 31
FFN_HIDDEN = -(-(8 * D_MODEL) // (3 * 256)) * 256
Q_BLOCK = 128
N_EVEN = (DEPTH + 1) // 2
N_ODD = DEPTH // 2
DEEPNORM_ALPHA = (2 * DEPTH) ** 0.25
DEEPNORM_BETA = (8 * DEPTH) ** -0.25
LN_EPS = 1e-5
ALIBI_SLOPES = np.array([2.0 ** (-8.0 * (h + 1) / DIFF_HEADS) for h in range(DIFF_HEADS)], dtype=np.float32)

kernel_name = "stickbreak_diffattn_conformer_hybrid"


def layer_norm(x, g, b):
    xf = x.astype(jnp.float32)
    mu = jnp.mean(xf, axis=-1, keepdims=True)
    var = jnp.mean(jnp.square(xf - mu), axis=-1, keepdims=True)
    return ((xf - mu) * lax.rsqrt(var + LN_EPS)).astype(x.dtype) * g + b


def rms_norm(x, g):
    xf = x.astype(jnp.float32)
    ms = jnp.mean(jnp.square(xf), axis=-1, keepdims=True)
    return (xf * lax.rsqrt(ms + LN_EPS)).astype(x.dtype) * g


def stick_breaking_block(q, k, v, t0):
    qb, sk = q.shape[1], k.shape[1]
    z = jnp.einsum('bqhd,bkhd->bhqk', q, k).astype(jnp.float32) / math.sqrt(HEAD_DIM)
    tpos = t0 + jnp.arange(qb)
    spos = jnp.arange(sk)
    strict = spos[None, :] < tpos[:, None]
    log_1mb = jnp.where(strict, jax.nn.log_sigmoid(-z), 0.0)
    between = lax.cumsum(log_1mb, axis=3, reverse=True) - log_1mb
    a = jnp.where(strict, jnp.exp(jax.nn.log_sigmoid(z) + between), 0.0)
    return jnp.einsum('bhqk,bkhd->bqhd', a.astype(v.dtype), v)


def diff_attention_block(q, k, v, t0, lam):
    qb, sk = q.shape[1], k.shape[1]
    s = jnp.einsum('bqhmd,bkhmd->bmhqk', q, k).astype(jnp.float32) / math.sqrt(HEAD_DIM)
    tpos = t0 + jnp.arange(qb)
    spos = jnp.arange(sk)
    dist = (tpos[:, None] - spos[None, :]).astype(jnp.float32)
    bias = -jnp.asarray(ALIBI_SLOPES)[:, None, None] * dist
    causal = spos[None, :] <= tpos[:, None]
    s = jnp.where(causal, s + bias, -jnp.inf)
    p = jax.nn.softmax(s, axis=-1)
    w = p[:, 0] - lam * p[:, 1]
    return jnp.einsum('bhqk,bkhe->bqhe', w.astype(v.dtype), v)


def attention_mixer(h, w_in, w_out, lq1, lk1, lq2, lk2, subln_g, lambda_init):
    bsz, seq, _ = h.shape
    proj = h @ w_in
    o0 = 0
    def take(width):
        nonlocal o0
        part = proj[..., o0:o0 + width]
        o0 += width
        return part
    q_sb = take(SB_WIDTH).reshape(bsz, seq, SB_HEADS, HEAD_DIM)
    k_sb = take(SB_WIDTH).reshape(bsz, seq, SB_HEADS, HEAD_DIM)
    v_sb = take(SB_WIDTH).reshape(bsz, seq, SB_HEADS, HEAD_DIM)
    q_df = take(DIFF_QK_WIDTH).reshape(bsz, seq, DIFF_HEADS, 2, HEAD_DIM)
    k_df = take(DIFF_QK_WIDTH).reshape(bsz, seq, DIFF_HEADS, 2, HEAD_DIM)
    v_df = take(DIFF_V_WIDTH).reshape(bsz, seq, DIFF_HEADS, DIFF_V_DIM)
    f32 = jnp.float32
    lam = (jnp.exp(jnp.sum(lq1.astype(f32) * lk1.astype(f32)))
           - jnp.exp(jnp.sum(lq2.astype(f32) * lk2.astype(f32))) + lambda_init)
    sb_out, df_out = [], []
    for blk in range(seq // Q_BLOCK):
        t0 = blk * Q_BLOCK
        t1 = t0 + Q_BLOCK
        sb_out.append(stick_breaking_block(q_sb[:, t0:t1], k_sb[:, :t1], v_sb[:, :t1], t0))
        df_out.append(diff_attention_block(q_df[:, t0:t1], k_df[:, :t1], v_df[:, :t1], t0, lam))
    o_sb = jnp.concatenate(sb_out, axis=1).reshape(bsz, seq, SB_WIDTH)
    o_df = rms_norm(jnp.concatenate(df_out, axis=1), subln_g) * (1.0 - lambda_init)
    o_df = o_df.reshape(bsz, seq, DIFF_V_WIDTH)
    return jnp.concatenate([o_sb, o_df], axis=-1) @ w_out


def conv_mixer(h, pw1_w, pw1_b, dw_w, dw_b, cln_g, cln_b, pw2_w, pw2_b):
    u = jax.nn.glu(h @ pw1_w + pw1_b, axis=-1)
    u = lax.conv_general_dilated(
        u, dw_w, window_strides=(1,), padding=[(CONV_WIDTH - 1, 0)],
        dimension_numbers=('NWC', 'WIO', 'NWC'), feature_group_count=D_MODEL) + dw_b
    u = jax.nn.silu(layer_norm(u, cln_g, cln_b))
    return u @ pw2_w + pw2_b


def swiglu(h, wg, wu, wd):
    return (jax.nn.silu(h @ wg) * (h @ wu)) @ wd


def setup_inputs(seed: int = 0) -> dict:
    key = jax.random.key(seed)
    ks = jax.random.split(key, 24)
    nrm = jax.random.normal
    f32 = jnp.float32
    x = nrm(ks[0], (BATCH, SEQ, D_MODEL), f32)
    w_in = nrm(ks[1], (N_EVEN, D_MODEL, IN_WIDTH), f32) * D_MODEL ** -0.5
    col = np.arange(IN_WIDTH)
    v_sb_cols = (col >= 2 * SB_WIDTH) & (col < 3 * SB_WIDTH)
    v_df_cols = col >= 3 * SB_WIDTH + 2 * DIFF_QK_WIDTH
    col_scale = np.where(v_sb_cols | v_df_cols, DEEPNORM_BETA, 1.0).astype(np.float32)
    w_in = w_in * jnp.asarray(col_scale)
    w_out = nrm(ks[2], (N_EVEN, MIX_WIDTH, D_MODEL), f32) * MIX_WIDTH ** -0.5 * DEEPNORM_BETA
    lq1 = nrm(ks[3], (N_EVEN, HEAD_DIM), f32) * 0.1
    lk1 = nrm(ks[4], (N_EVEN, HEAD_DIM), f32) * 0.1
    lq2 = nrm(ks[5], (N_EVEN, HEAD_DIM), f32) * 0.1
    lk2 = nrm(ks[6], (N_EVEN, HEAD_DIM), f32) * 0.1
    subln_g = 1.0 + 0.02 * nrm(ks[7], (N_EVEN, DIFF_V_DIM), f32)
    pw1_w = nrm(ks[8], (N_ODD, D_MODEL, 2 * D_MODEL), f32) * D_MODEL ** -0.5
    pw1_b = 0.02 * nrm(ks[9], (N_ODD, 2 * D_MODEL), f32)
    dw_w = nrm(ks[10], (N_ODD, CONV_WIDTH, 1, D_MODEL), f32) * CONV_WIDTH ** -0.5
    dw_b = 0.02 * nrm(ks[11], (N_ODD, D_MODEL), f32)
    cln_g = 1.0 + 0.02 * nrm(ks[12], (N_ODD, D_MODEL), f32)
    cln_b = 0.02 * nrm(ks[13], (N_ODD, D_MODEL), f32)
    pw2_w = nrm(ks[14], (N_ODD, D_MODEL, D_MODEL), f32) * D_MODEL ** -0.5 * DEEPNORM_BETA
    pw2_b = 0.02 * nrm(ks[15], (N_ODD, D_MODEL), f32)
    mix_ln_g = 1.0 + 0.02 * nrm(ks[16], (DEPTH, D_MODEL), f32)
    mix_ln_b = 0.02 * nrm(ks[17], (DEPTH, D_MODEL), f32)
    ffn_wg = nrm(ks[18], (DEPTH, D_MODEL, FFN_HIDDEN), f32) * D_MODEL ** -0.5 * DEEPNORM_BETA
    ffn_wu = nrm(ks[19], (DEPTH, D_MODEL, FFN_HIDDEN), f32) * D_MODEL ** -0.5 * DEEPNORM_BETA
    ffn_wd = nrm(ks[20], (DEPTH, FFN_HIDDEN, D_MODEL), f32) * FFN_HIDDEN ** -0.5 * DEEPNORM_BETA
    ffn_ln_g = 1.0 + 0.02 * nrm(ks[21], (DEPTH, D_MODEL), f32)
    ffn_ln_b = 0.02 * nrm(ks[22], (DEPTH, D_MODEL), f32)
    return {"x": x, "attn_w_in": w_in, "attn_w_out": w_out,
            "diff_lambda_q1": lq1, "diff_lambda_k1": lk1,
            "diff_lambda_q2": lq2, "diff_lambda_k2": lk2, "diff_subln_g": subln_g,
            "conv_pw1_w": pw1_w, "conv_pw1_b": pw1_b, "conv_dw_w": dw_w, "conv_dw_b": dw_b,
            "conv_ln_g": cln_g, "conv_ln_b": cln_b, "conv_pw2_w": pw2_w, "conv_pw2_b": pw2_b,
            "mix_ln_g": mix_ln_g, "mix_ln_b": mix_ln_b,
            "ffn_w_gate": ffn_wg, "ffn_w_up": ffn_wu, "ffn_w_down": ffn_wd,
            "ffn_ln_g": ffn_ln_g, "ffn_ln_b": ffn_ln_b}


def reference(x, attn_w_in, attn_w_out, diff_lambda_q1, diff_lambda_k1,
              diff_lambda_q2, diff_lambda_k2, diff_subln_g,
              conv_pw1_w, conv_pw1_b, conv_dw_w, conv_dw_b, conv_ln_g, conv_ln_b,
              conv_pw2_w, conv_pw2_b, mix_ln_g, mix_ln_b,
              ffn_w_gate, ffn_w_up, ffn_w_down, ffn_ln_g, ffn_ln_b):
    h = x
    for i in range(DEPTH):
        if i % 2 == 0:
            e = i // 2
            lambda_init = 0.8 - 0.6 * math.exp(-0.3 * i)
            m = attention_mixer(h, attn_w_in[e], attn_w_out[e],
                                diff_lambda_q1[e], diff_lambda_k1[e],
                                diff_lambda_q2[e], diff_lambda_k2[e],
                                diff_subln_g[e], lambda_init)
        else:
            o = i // 2
            m = conv_mixer(h, conv_pw1_w[o], conv_pw1_b[o], conv_dw_w[o], conv_dw_b[o],
                           conv_ln_g[o], conv_ln_b[o], conv_pw2_w[o], conv_pw2_b[o])
        h = layer_norm(DEEPNORM_ALPHA * h + m, mix_ln_g[i], mix_ln_b[i])
        f = swiglu(h, ffn_w_gate[i], ffn_w_up[i], ffn_w_down[i])
        h = layer_norm(DEEPNORM_ALPHA * h + f, ffn_ln_g[i], ffn_ln_b[i])
    return h
```

```cpp
#include <hip/hip_runtime.h>
#include <hip/hip_cooperative_groups.h>
#include <cstdio>
#include <cstdint>
namespace cg = cooperative_groups;

#ifndef MK_ONE_LAUNCH
#define MK_ONE_LAUNCH 0
#endif

#define LAS __attribute__((address_space(3)))
typedef unsigned short bf16_t;
typedef short bf16x8 __attribute__((ext_vector_type(8)));
typedef float f32x2 __attribute__((ext_vector_type(2)));
typedef float f32x4 __attribute__((ext_vector_type(4)));
typedef float f32x16 __attribute__((ext_vector_type(16)));
typedef unsigned u32x2 __attribute__((ext_vector_type(2)));
typedef unsigned u32x4 __attribute__((ext_vector_type(4)));

constexpr int NB = 16, SEQ = 2048, DM = 1024, MTOK = NB * SEQ, FF = 2816, NQK = 2048, CONVW = 31;
constexpr float LN_EPS = 1e-5f;
constexpr float ALPHA = 1.41421356237309515f;
constexpr float LOG2E = 1.4426950408889634f;
constexpr float LAMBDA_INIT = 0.2f;

constexpr size_t MiB = 1u << 20;
constexpr size_t WS_WQK = 0, WS_WV = 4 * MiB, WS_WOUT = 6 * MiB, WS_WGU0 = 8 * MiB, WS_WD0 = 19 * MiB, WS_WGU1 = 25 * MiB, WS_WD1 = 36 * MiB,
                 WS_WPW1 = 42 * MiB, WS_WPW2 = 46 * MiB, WS_XB = 48 * MiB, WS_QK = 112 * MiB, WS_VT = 240 * MiB, WS_HID = 112 * MiB,
                 WS_MIX = 304 * MiB, WS_U2 = 368 * MiB, WS_END = 432 * MiB;
constexpr int LDS_BYTES = 147456;

__device__ __forceinline__ unsigned cvt_pk_bf16(float lo, float hi) { unsigned r; asm volatile("v_cvt_pk_bf16_f32 %0, %1, %2" : "=v"(r) : "v"(lo), "v"(hi)); return r; }
__device__ __forceinline__ float bf_lo(unsigned w) { return __uint_as_float(w << 16); }
__device__ __forceinline__ float bf_hi(unsigned w) { return __uint_as_float(w & 0xffff0000u); }
__device__ __forceinline__ float fast_exp2(float x) { return __builtin_amdgcn_exp2f(x); }
__device__ __forceinline__ float fast_log2(float x) { return __builtin_amdgcn_logf(x); }
__device__ __forceinline__ float fast_rcp(float x) { return __builtin_amdgcn_rcpf(x); }
__device__ __forceinline__ float sigmoidf_(float x) { return fast_rcp(1.f + fast_exp2(-x * LOG2E)); }
__device__ __forceinline__ float siluf_(float x) { return x * sigmoidf_(x); }

namespace pg8 {
constexpr int BM = 256, BK = 64, HALF = 128, HTB = HALF * BK * 2, STAGE_BYTES = 8 * HTB, NXCD = 8, WGM = 8;
__host__ __device__ __forceinline__ int lds_byte(int r, int c) { const int st = (r >> 4) * 2 + (c >> 5), rr = r & 15, cc = c & 31, ob = rr * 64 + cc * 2; return st * 1024 + (ob ^ (((ob >> 9) & 1) << 5)); }
__host__ __device__ __forceinline__ void stage_rc(int b, int& R, int& C) { const int st = b / 1024, sb = b % 1024, swz = sb ^ (((sb >> 9) & 1) << 5); R = (st >> 1) * 16 + swz / 64; C = (st & 1) * 32 + (swz % 64) / 2; }
__host__ __device__ __forceinline__ int perm32(int rho) { const int n = rho >> 4, i = rho & 15; return 8 * (i >> 2) + 4 * n + (i & 3); }

struct Unit { int pm, pn; };
struct Gemm { const bf16_t* A; const bf16_t* Bt; int M, N, K; };

struct StaticOrder {
    int nM, nN, nwg, G, c;
    __device__ void init(int M, int N, int G_, int c_) { nM = M / BM; nN = N / BM; nwg = nM * nN; G = G_; c = c_; }
    __device__ bool next(int i, Unit& u) const {
        const long L = (long)i * G + c; if (L >= nwg) return false;
        int wgid = (int)L; { const int q = nwg / NXCD, r = nwg % NXCD, xcd = wgid % NXCD, off = wgid / NXCD; wgid = (xcd < r ? xcd * (q + 1) : r * (q + 1) + (xcd - r) * q) + off; }
        const int nig = WGM * nN, gid = wgid / nig, fm = gid * WGM, gsz = (nM - fm) < WGM ? (nM - fm) : WGM;
        u.pm = fm + ((wgid % nig) % gsz); u.pn = (wgid % nig) / gsz; return true;
    }
};

struct EpiBf16 {
    static constexpr bool PERM = true;
    bf16_t* O; int ldc;
    __device__ __forceinline__ void operator()(const f32x4 (&acc)[2][2][4][2], const Unit& u, int wr, int wc, int fr, int fq) const {
        const int row0 = u.pm * BM + wr * 64 + fr, col0 = u.pn * BM + wc * 32 + 8 * fq;
#pragma unroll
        for (int ai = 0; ai < 2; ++ai)
#pragma unroll
            for (int m = 0; m < 4; ++m) { bf16_t* rowp = O + (size_t)(row0 + ai * HALF + m * 16) * ldc + col0;
#pragma unroll
                for (int bj = 0; bj < 2; ++bj) { const f32x4 v0 = acc[ai][bj][m][0], v1 = acc[ai][bj][m][1];
                    u32x4 w; w.x = cvt_pk_bf16(v0[0], v0[1]); w.y = cvt_pk_bf16(v0[2], v0[3]); w.z = cvt_pk_bf16(v1[0], v1[1]); w.w = cvt_pk_bf16(v1[2], v1[3]);
                    *(u32x4*)(rowp + bj * HALF) = w; } }
    }
};
template <int MODE  > struct EpiGated {
    static constexpr bool PERM = true;
    bf16_t* O; int ldc; const float* bias; int bias_b_off;
    __device__ __forceinline__ void operator()(const f32x4 (&acc)[2][2][4][2], const Unit& u, int wr, int wc, int fr, int fq) const {
        const int row0 = u.pm * BM + wr * 64 + fr, col0 = u.pn * HALF + wc * 32 + 8 * fq;
        f32x4 ba[2], bb[2];
#pragma unroll
        for (int n = 0; n < 2; ++n) { if (MODE == 1) { ba[n] = *(const f32x4*)(bias + col0 + 4 * n); bb[n] = *(const f32x4*)(bias + bias_b_off + col0 + 4 * n); } else { ba[n] = (f32x4){0.f, 0.f, 0.f, 0.f}; bb[n] = ba[n]; } }
#pragma unroll
        for (int ai = 0; ai < 2; ++ai)
#pragma unroll
            for (int m = 0; m < 4; ++m) { bf16_t* rowp = O + (size_t)(row0 + ai * HALF + m * 16) * ldc + col0;
                float o[8];
#pragma unroll
                for (int n = 0; n < 2; ++n) { const f32x4 a = acc[ai][0][m][n] + ba[n], b = acc[ai][1][m][n] + bb[n];
#pragma unroll
                    for (int e = 0; e < 4; ++e) o[4 * n + e] = (MODE == 0) ? siluf_(a[e]) * b[e] : a[e] * sigmoidf_(b[e]); }
                u32x4 w; w.x = cvt_pk_bf16(o[0], o[1]); w.y = cvt_pk_bf16(o[2], o[3]); w.z = cvt_pk_bf16(o[4], o[5]); w.w = cvt_pk_bf16(o[6], o[7]);
                *(u32x4*)rowp = w; }
    }
};
struct EpiRes {
    static constexpr bool PERM = false;
    const float* base; float* out; int ldc; const float* bias;
    __device__ __forceinline__ void operator()(const f32x4 (&acc)[2][2][4][2], const Unit& u, int wr, int wc, int fr, int fq) const {
        const int col0 = u.pn * BM + wc * 32 + 4 * fq;
        f32x4 bv[2][2];
#pragma unroll
        for (int bj = 0; bj < 2; ++bj)
#pragma unroll
            for (int n = 0; n < 2; ++n) bv[bj][n] = bias ? *(const f32x4*)(bias + col0 + bj * HALF + n * 16) : (f32x4){0.f, 0.f, 0.f, 0.f};
#pragma unroll
        for (int ai = 0; ai < 2; ++ai)
#pragma unroll
            for (int m = 0; m < 4; ++m) { const size_t off = (size_t)(u.pm * BM + ai * HALF + wr * 64 + m * 16 + fr) * ldc + col0;
#pragma unroll
                for (int bj = 0; bj < 2; ++bj)
#pragma unroll
                    for (int n = 0; n < 2; ++n) { const f32x4 bs = *(const f32x4*)(base + off + bj * HALF + n * 16);
                        *(f32x4*)(out + off + bj * HALF + n * 16) = bs * ALPHA + acc[ai][bj][m][n] + bv[bj][n]; }
                asm volatile("" ::: "memory"); }
    }
};

template <class Epi>
__device__ __forceinline__ void gemm_phase(const int tid, LAS unsigned char* lds, const Gemm g, const StaticOrder& S, const Epi& E) {
    const int wid = __builtin_amdgcn_readfirstlane(tid >> 6), lane = tid & 63, wr = wid >> 2, wc = wid & 3, fr = lane & 15, fq = lane >> 4;
    const int K = g.K, nt = K / BK;
    unsigned voffA[2], voffB[2];
#pragma unroll
    for (int i = 0; i < 2; ++i) { int R, C; stage_rc(tid * 16 + i * 8192, R, C); const int Rb = Epi::PERM ? ((R & ~31) + perm32(R & 31)) : R;
        voffA[i] = (unsigned)(R * K + C) * 2u; voffB[i] = (unsigned)(Rb * K + C) * 2u; }
    const size_t kstep = (size_t)(BK * 2);
    const size_t hstep = (size_t)HALF * K * 2;
    const size_t tstep = 2 * hstep;
    const unsigned ldsw = (unsigned)wid * 1024u;
    const int aoff = lds_byte(wr * 64 + fr, fq * 8), boff = lds_byte(wc * 32 + fr, fq * 8);
#define PG8_SA(b, h) (((b) * 2 + (h)) * HTB)
#define PG8_SB(b, h) ((4 + (b) * 2 + (h)) * HTB)
#define PG8_STAGE(bufoff, gbase, voff) do { _Pragma("unroll") for (int _i = 0; _i < 2; ++_i) \
        __builtin_amdgcn_global_load_lds((const unsigned*)((const char*)(gbase) + (voff)[_i]), (LAS unsigned*)(lds + (bufoff) + ldsw + _i * 8192), 16, 0, 0); } while (0)
#define PG8_LDA(dst, b, h) do { _Pragma("unroll") for (int m = 0; m < 4; ++m) _Pragma("unroll") for (int k = 0; k < 2; ++k) dst[m][k] = *(const LAS bf16x8*)(lds + PG8_SA(b, h) + aoff + m * 2048 + k * 1024); } while (0)
#define PG8_LDB(dst, b, h) do { _Pragma("unroll") for (int n = 0; n < 2; ++n) _Pragma("unroll") for (int k = 0; k < 2; ++k) dst[n][k] = *(const LAS bf16x8*)(lds + PG8_SB(b, h) + boff + n * 2048 + k * 1024); } while (0)
#define PG8_MMA(ai, bj, At, Bt) do { __builtin_amdgcn_s_setprio(1); _Pragma("unroll") for (int m = 0; m < 4; ++m) _Pragma("unroll") for (int n = 0; n < 2; ++n) _Pragma("unroll") for (int k = 0; k < 2; ++k) \
        acc[ai][bj][m][n] = __builtin_amdgcn_mfma_f32_16x16x32_bf16(Bt[n][k], At[m][k], acc[ai][bj][m][n], 0, 0, 0); __builtin_amdgcn_s_setprio(0); } while (0)
#define PG8_WAIT_V(n) asm volatile("s_waitcnt vmcnt(" #n ")" ::: "memory")
#define PG8_WAIT_L(n) asm volatile("s_waitcnt lgkmcnt(" #n ")" ::: "memory")
#define PG8_BAR __builtin_amdgcn_s_barrier()
#define PG8_SCHED __builtin_amdgcn_sched_barrier(0)
    Unit cur, nxt; int ui = 0;
    if (!S.next(0, cur)) return;
    f32x4 acc[2][2][4][2];
#pragma unroll
    for (int a = 0; a < 2; ++a)
#pragma unroll
        for (int b = 0; b < 2; ++b)
#pragma unroll
            for (int m = 0; m < 4; ++m)
#pragma unroll
                for (int n = 0; n < 2; ++n) acc[a][b][m][n] = (f32x4){0.f, 0.f, 0.f, 0.f};
    bf16x8 At[4][2], B0[2][2], B1[2][2];
    const char* cA = (const char*)g.A + (size_t)cur.pm * tstep; const char* cB = (const char*)g.Bt + (size_t)cur.pn * tstep;
    PG8_STAGE(PG8_SB(0, 0), cB, voffB); PG8_STAGE(PG8_SB(0, 1), cB + hstep, voffB); PG8_STAGE(PG8_SA(0, 0), cA, voffA); PG8_STAGE(PG8_SA(0, 1), cA + hstep, voffA);
    if (wr == 1) PG8_BAR;
    PG8_WAIT_V(2); PG8_BAR;
    PG8_STAGE(PG8_SB(1, 0), cB + kstep, voffB); PG8_STAGE(PG8_SA(1, 0), cA + kstep, voffA); PG8_STAGE(PG8_SB(1, 1), cB + hstep + kstep, voffB);
    PG8_WAIT_V(6); PG8_BAR;
    for (;;) {
        const bool has_next = S.next(ui + 1, nxt);
        const char* nA = has_next ? (const char*)g.A + (size_t)nxt.pm * tstep : cA; const char* nB = has_next ? (const char*)g.Bt + (size_t)nxt.pn * tstep : cB;
        for (int t = 0; t < nt; t += 2) {
            const bool last = (t == nt - 2);
            const char* a1 = cA + (size_t)(t + 1) * kstep;
            const char* a2 = last ? nA : cA + (size_t)(t + 2) * kstep; const char* b2 = last ? nB : cB + (size_t)(t + 2) * kstep;
            const char* a3 = a2 + kstep; const char* b3 = b2 + kstep;
            PG8_LDB(B0, 0, 0); PG8_LDB(B1, 0, 1); PG8_SCHED; PG8_LDA(At, 0, 0); PG8_STAGE(PG8_SA(1, 1), a1 + hstep, voffA);
            PG8_WAIT_V(8); PG8_WAIT_L(0); PG8_BAR; PG8_MMA(0, 0, At, B0); PG8_MMA(0, 1, At, B1); PG8_BAR; PG8_SCHED;
            PG8_LDA(At, 0, 1); PG8_STAGE(PG8_SB(0, 0), b2, voffB); PG8_STAGE(PG8_SB(0, 1), b2 + hstep, voffB); PG8_STAGE(PG8_SA(0, 0), a2, voffA);
            PG8_WAIT_V(8); PG8_WAIT_L(0); PG8_BAR; PG8_MMA(1, 0, At, B0); PG8_MMA(1, 1, At, B1); PG8_BAR; PG8_SCHED;
            PG8_LDB(B0, 1, 0); PG8_LDB(B1, 1, 1); PG8_SCHED; PG8_LDA(At, 1, 0); PG8_STAGE(PG8_SA(0, 1), a2 + hstep, voffA);
            PG8_WAIT_V(8); PG8_WAIT_L(0); PG8_BAR; PG8_MMA(0, 0, At, B0); PG8_MMA(0, 1, At, B1); PG8_BAR; PG8_SCHED;
            PG8_LDA(At, 1, 1); PG8_STAGE(PG8_SB(1, 0), b3, voffB); PG8_STAGE(PG8_SB(1, 1), b3 + hstep, voffB); PG8_STAGE(PG8_SA(1, 0), a3, voffA);
            PG8_WAIT_V(8); PG8_WAIT_L(0); PG8_BAR; PG8_MMA(1, 0, At, B0); PG8_MMA(1, 1, At, B1); PG8_BAR; PG8_SCHED;
        }
        if (wr == 0) PG8_BAR;
        E(acc, cur, wr, wc, fr, fq);
        if (!has_next) break;
#pragma unroll
        for (int a = 0; a < 2; ++a)
#pragma unroll
            for (int b = 0; b < 2; ++b)
#pragma unroll
                for (int m = 0; m < 4; ++m)
#pragma unroll
                    for (int n = 0; n < 2; ++n) acc[a][b][m][n] = (f32x4){0.f, 0.f, 0.f, 0.f};
        cur = nxt; cA = nA; cB = nB; ++ui;
        if (wr == 1) PG8_BAR;
    }
    PG8_WAIT_V(0);
    PG8_BAR;
#undef PG8_SA
#undef PG8_SB
#undef PG8_STAGE
#undef PG8_LDA
#undef PG8_LDB
#undef PG8_MMA
#undef PG8_WAIT_V
#undef PG8_WAIT_L
#undef PG8_BAR
#undef PG8_SCHED
}
}

__device__ __forceinline__ void tr_item(const float* W, int K, int N, bf16_t* WT, int k0, int n0, int drow0, float scale, LAS float* scr, int lane) {
#pragma unroll 8
    for (int i = 0; i < 32; ++i) { const int kk = 2 * i + (lane >> 5); scr[kk * 33 + (lane & 31)] = W[(size_t)(k0 + kk) * N + n0 + (lane & 31)]; }
    asm volatile("s_waitcnt lgkmcnt(0)" ::: "memory");
    const int c = lane & 7;
#pragma unroll
    for (int j = 0; j < 4; ++j) { const int n = (lane >> 3) + 8 * j; const LAS float* s = scr + (8 * c) * 33 + n;
        u32x4 o; o.x = cvt_pk_bf16(s[0 * 33] * scale, s[1 * 33] * scale); o.y = cvt_pk_bf16(s[2 * 33] * scale, s[3 * 33] * scale);
        o.z = cvt_pk_bf16(s[4 * 33] * scale, s[5 * 33] * scale); o.w = cvt_pk_bf16(s[6 * 33] * scale, s[7 * 33] * scale);
        *(u32x4*)(WT + (size_t)(drow0 + n) * K + k0 + 8 * c) = o; }
    asm volatile("s_waitcnt lgkmcnt(0)" ::: "memory");
}

struct Args { const float* in[23]; float* out; unsigned char* ws; int lo, hi; };
typedef const __attribute__((address_space(4))) Args CArgs;

__device__ __forceinline__ void prologue_phase(const int tid, const int bx, const int G, CArgs* A, LAS unsigned char* lds) {
    const int lane = tid & 63, wid = __builtin_amdgcn_readfirstlane(tid >> 6);
    LAS float* scr = (LAS float*)(lds + wid * 16384);
    const int gw = bx * 8 + wid, NGW = G * 8;
    unsigned char* ws = A->ws;
    constexpr int I_IN = 16 * 96, I_SQ = 16 * 32, I_GU = 16 * 88, I_D = 44 * 32, I_PW1 = 16 * 64;
    constexpr int NITEMS = I_IN + I_SQ + 6 * I_GU + I_PW1 + I_SQ;
    static_assert(I_GU == I_D, "item counts");
    for (int it = gw; it < NITEMS; it += NGW) {
        int r = it;
        if (r < I_IN) {
            const int nblk = 96, kb = r / nblk, nb = r % nblk, n0 = 32 * nb, seg = n0 >> 9, w = n0 & 511;
            bf16_t* dst; int drow; float sc = 1.f;
            if (seg == 0) { dst = (bf16_t*)(ws + WS_WQK); drow = w; sc = 0.125f * LOG2E; }
            else if (seg == 1) { dst = (bf16_t*)(ws + WS_WQK); drow = 512 + w; }
            else if (seg == 2) { dst = (bf16_t*)(ws + WS_WV); drow = w; }
            else if (seg == 3) { dst = (bf16_t*)(ws + WS_WQK); drow = 1024 + w; sc = 0.125f * LOG2E; }
            else if (seg == 4) { dst = (bf16_t*)(ws + WS_WQK); drow = 1536 + w; }
            else { dst = (bf16_t*)(ws + WS_WV); drow = 512 + w; }
            tr_item(A->in[1], 1024, 3072, dst, 64 * kb, n0, drow, sc, scr, lane); continue; }
        r -= I_IN;
        if (r < I_SQ) { const int kb = r / 32, nb = r % 32; tr_item(A->in[2], 1024, 1024, (bf16_t*)(ws + WS_WOUT), 64 * kb, 32 * nb, 32 * nb, 1.f, scr, lane); continue; }
        r -= I_SQ;
        if (r < 6 * I_GU) {
            const int which = r / I_GU, q = r % I_GU, layer = which / 3, kind = which % 3;
            if (kind < 2) { const int kb = q / 88, nb = q % 88, n0 = 32 * nb, drow = 256 * (n0 >> 7) + 128 * kind + (n0 & 127);
                tr_item((kind ? A->in[19] : A->in[18]) + (size_t)layer * 1024 * FF, 1024, FF, (bf16_t*)(ws + (layer ? WS_WGU1 : WS_WGU0)), 64 * kb, n0, drow, 1.f, scr, lane); }
            else { const int kb = q / 32, nb = q % 32;
                tr_item(A->in[20] + (size_t)layer * FF * 1024, FF, 1024, (bf16_t*)(ws + (layer ? WS_WD1 : WS_WD0)), 64 * kb, 32 * nb, 32 * nb, 1.f, scr, lane); }
            continue; }
        r -= 6 * I_GU;
        if (r < I_PW1) { const int kb = r / 64, nb = r % 64, n0 = 32 * nb, half = n0 >> 10, w = n0 & 1023, drow = 256 * (w >> 7) + 128 * half + (w & 127);
            tr_item(A->in[8], 1024, 2048, (bf16_t*)(ws + WS_WPW1), 64 * kb, n0, drow, 1.f, scr, lane); continue; }
        r -= I_PW1;
        { const int kb = r / 32, nb = r % 32; tr_item(A->in[14], 1024, 1024, (bf16_t*)(ws + WS_WPW2), 64 * kb, 32 * nb, 32 * nb, 1.f, scr, lane); }
    }
    const float* x = A->in[0]; bf16_t* xb = (bf16_t*)(ws + WS_XB);
    const size_t n8 = (size_t)MTOK * DM / 8;
    for (size_t i = (size_t)bx * 512 + tid; i < n8; i += (size_t)G * 512) {
        const f32x4 a = *(const f32x4*)(x + i * 8), b = *(const f32x4*)(x + i * 8 + 4);
        u32x4 w; w.x = cvt_pk_bf16(a[0], a[1]); w.y = cvt_pk_bf16(a[2], a[3]); w.z = cvt_pk_bf16(b[0], b[1]); w.w = cvt_pk_bf16(b[2], b[3]);
        *(u32x4*)(xb + i * 8) = w; }
}

__device__ __forceinline__ float wave_sum(float v) {
#pragma unroll
    for (int o = 1; o < 64; o <<= 1) v += __shfl_xor(v, o);
    return v;
}
__device__ __forceinline__ void ln_phase(const int tid, const int bx, const int G, float* Y, const float* g, const float* bta, bf16_t* XB) {
    const int lane = tid & 63, wid = tid >> 6;
    const int gw = bx * 8 + wid, NGW = G * 8;
    f32x4 gv[4], bv[4];
#pragma unroll
    for (int j = 0; j < 4; ++j) { gv[j] = *(const f32x4*)(g + 4 * lane + 256 * j); bv[j] = *(const f32x4*)(bta + 4 * lane + 256 * j); }
    for (int m = gw; m < MTOK; m += NGW) {
        float* yr = Y + (size_t)m * DM + 4 * lane;
        f32x4 v[4]; float s = 0.f;
#pragma unroll
        for (int j = 0; j < 4; ++j) { v[j] = *(const f32x4*)(yr + 256 * j); s += (v[j][0] + v[j][1]) + (v[j][2] + v[j][3]); }
        const float mean = wave_sum(s) * (1.f / DM); float s2 = 0.f;
#pragma unroll
        for (int j = 0; j < 4; ++j) { v[j] = v[j] - mean; s2 += (v[j][0] * v[j][0] + v[j][1] * v[j][1]) + (v[j][2] * v[j][2] + v[j][3] * v[j][3]); }
        const float rstd = 1.f / sqrtf(wave_sum(s2) * (1.f / DM) + LN_EPS);
        bf16_t* xr = XB + (size_t)m * DM + 4 * lane;
#pragma unroll
        for (int j = 0; j < 4; ++j) { const f32x4 o = v[j] * rstd * gv[j] + bv[j]; *(f32x4*)(yr + 256 * j) = o;
            u32x2 w; w.x = cvt_pk_bf16(o[0], o[1]); w.y = cvt_pk_bf16(o[2], o[3]); *(u32x2*)(xr + 256 * j) = w; }
    }
}

__device__ __forceinline__ void conv_phase(const int tid, const int bx, const int G, LAS unsigned char* lds, const bf16_t* U, bf16_t* U2, const float* dww, const float* dwb, const float* cg_, const float* cb_) {
    const int c0 = 2 * tid;
    float w[CONVW][2];
#pragma unroll
    for (int j = 0; j < CONVW; ++j) { const f32x2 t = *(const f32x2*)(dww + j * DM + c0); w[j][0] = t[0]; w[j][1] = t[1]; }
    const f32x2 db = *(const f32x2*)(dwb + c0), gg = *(const f32x2*)(cg_ + c0), bb = *(const f32x2*)(cb_ + c0);
    LAS float* psum = (LAS float*)lds; LAS float* psq = (LAS float*)(lds + 65536); LAS f32x2* stats = (LAS f32x2*)(lds + 131072);
    constexpr int TT = 16;
    for (int unit = bx; unit < MTOK / TT; unit += G) {
        const int b = unit / (SEQ / TT), s0 = (unit % (SEQ / TT)) * TT;
        float acc[TT][2];
#pragma unroll
        for (int t = 0; t < TT; ++t) { acc[t][0] = db[0]; acc[t][1] = db[1]; }
        const bf16_t* ub = U + ((size_t)b * SEQ + s0) * DM + c0;
#pragma unroll
        for (int i = 0; i < TT + CONVW - 1; ++i) {
            const int s = s0 - (CONVW - 1) + i;
            unsigned raw = 0u;
            if (s >= 0) raw = *(const unsigned*)(ub + (ptrdiff_t)(i - (CONVW - 1)) * DM);
            const float u0 = bf_lo(raw), u1 = bf_hi(raw);
#pragma unroll
            for (int t = 0; t < TT; ++t) { const int j = i - t; if (j >= 0 && j < CONVW) { acc[t][0] += w[j][0] * u0; acc[t][1] += w[j][1] * u1; } }
            if ((i & 7) == 7) asm volatile("" ::: "memory");
        }
#pragma unroll
        for (int t = 0; t < TT; ++t) { psum[t * 512 + tid] = acc[t][0] + acc[t][1]; psq[t * 512 + tid] = acc[t][0] * acc[t][0] + acc[t][1] * acc[t][1]; }
        __syncthreads();
        { const int t = tid >> 5, j = tid & 31; float s = 0.f, q = 0.f;
#pragma unroll
            for (int i = 0; i < 16; ++i) { s += psum[t * 512 + j + 32 * i]; q += psq[t * 512 + j + 32 * i]; }
#pragma unroll
            for (int o = 1; o < 32; o <<= 1) { s += __shfl_xor(s, o); q += __shfl_xor(q, o); }
            if (j == 0) { const float mean = s * (1.f / DM); const float var = fmaxf(q * (1.f / DM) - mean * mean, 0.f); stats[t] = (f32x2){mean, 1.f / sqrtf(var + LN_EPS)}; } }
        __syncthreads();
        bf16_t* ob = U2 + ((size_t)b * SEQ + s0) * DM + c0;
#pragma unroll
        for (int t = 0; t < TT; ++t) { const f32x2 st = stats[t];
            const float y0 = (acc[t][0] - st[0]) * st[1] * gg[0] + bb[0], y1 = (acc[t][1] - st[0]) * st[1] * gg[1] + bb[1];
            *(unsigned*)(ob + (size_t)t * DM) = cvt_pk_bf16(siluf_(y0), siluf_(y1)); }
    }
}

namespace att {
constexpr int KSTR = 272, VSTR = 144, KBYTES = 64 * KSTR, VBYTES = 128 * VSTR, BUFB = KBYTES + VBYTES;
constexpr int FLAG_OFF = 2 * BUFB;
constexpr float DONE_THR = -152.f;

template <bool SB>
__device__ __forceinline__ void unit(const int tid, LAS unsigned char* lds, const bf16_t* QK, const bf16_t* VT, bf16_t* MIX, int b, int P, int qb, float lam, const float* subg) {
    const int lane = tid & 63, wid = __builtin_amdgcn_readfirstlane(tid >> 6), g = wid >> 1, mu = wid & 1, r32 = lane & 31, hi = lane >> 5;
    const int q0 = qb * 128, qw0 = q0 + 32 * g, qabs = qw0 + r32;
    const size_t rowbase = (size_t)b * SEQ;
    const int qcol = (P < 4 ? 128 * P : 1024 + 128 * (P - 4)) + 64 * mu;
    const int kcol = (P < 4 ? 512 + 128 * P : 1536 + 128 * (P - 4));
    const int Tlast = q0 / 64 + 1, Tw = q0 / 64 + (g >> 1);
    bf16x8 qr[4];
    { const bf16_t* qp = QK + (rowbase + qabs) * NQK + qcol + 8 * hi;
#pragma unroll
        for (int d0 = 0; d0 < 4; ++d0) qr[d0] = *(const bf16x8*)(qp + 16 * d0); }
    const bf16_t* ksrc[2]; const bf16_t* vsrc[2]; int kdst[2], vdst[2];
#pragma unroll
    for (int i = 0; i < 2; ++i) { const int p = tid + 512 * i;
        ksrc[i] = QK + (rowbase + (p >> 4)) * NQK + kcol + (p & 15) * 8; kdst[i] = (p >> 4) * KSTR + (p & 15) * 16;
        vsrc[i] = VT + (size_t)(128 * P + (p >> 3)) * MTOK + rowbase + (p & 7) * 8; vdst[i] = KBYTES + (p >> 3) * VSTR + (p & 7) * 16; }
    u32x4 kst[2], vst[2];
#define ATT_LOAD(T) do { _Pragma("unroll") for (int i = 0; i < 2; ++i) { kst[i] = *(const u32x4*)(ksrc[i] + (size_t)(T) * 64 * NQK); vst[i] = *(const u32x4*)(vsrc[i] + (T) * 64); } } while (0)
    const int pi_row = (r32 & 0x13) | ((r32 & 4) << 1) | ((r32 & 8) >> 1);
    const int kfrag = pi_row * KSTR + mu * 128 + hi * 16;
    constexpr int NDB = SB ? 2 : 4;
    const int vfrag = KBYTES + ((SB ? 64 * mu : 0) + r32) * VSTR + hi * 16;
    f32x16 o[NDB];
#pragma unroll
    for (int d = 0; d < NDB; ++d) o[d] = (f32x16){};
    float carry = 0.f;
    bool done = false;
    float mrun = -INFINITY, lrun = 0.f;
    const float slope2 = SB ? 0.f : exp2f(-2.0f * (float)(P - 4 + 1)) * LOG2E;
    LAS unsigned* flags = (LAS unsigned*)(lds + FLAG_OFF);
    int buf = 0;
    ATT_LOAD(SB ? Tlast : 0);
    for (int it = 0; it <= Tlast; ++it) {
        const int T = SB ? Tlast - it : it;
        LAS unsigned char* bufp = lds + buf * BUFB;
#pragma unroll
        for (int i = 0; i < 2; ++i) { *(LAS u32x4*)(bufp + kdst[i]) = kst[i]; *(LAS u32x4*)(bufp + vdst[i]) = vst[i]; }
        if (SB) { if (lane == 0) flags[buf * 8 + wid] = done ? 0u : 1u; }
        __syncthreads();
        if (SB) { unsigned any = 0u;
#pragma unroll
            for (int w = 0; w < 8; ++w) any |= flags[buf * 8 + w];
            if (!any) break; }
        if (it < Tlast) { const int Tn = SB ? T - 1 : T + 1; ATT_LOAD(Tn); }
        const bool active = (T <= Tw) && !(SB && done);
        if (active) {
            f32x16 p0, p1;
            if (SB) { p0 = (f32x16){}; p1 = (f32x16){}; }
            else {
                const float lanebase = -slope2 * (float)(qabs - 64 * T - 8 * hi);
#pragma unroll
                for (int r = 0; r < 16; ++r) { p0[r] = lanebase + slope2 * (float)(16 * (r >> 3) + (r & 7)); p1[r] = p0[r] + slope2 * 32.f; }
                if (64 * T + 63 > qw0) {
#pragma unroll
                    for (int r = 0; r < 16; ++r) { const int key = 64 * T + 16 * (r >> 3) + 8 * hi + (r & 7); if (key > qabs) p0[r] = -INFINITY; if (key + 32 > qabs) p1[r] = -INFINITY; } }
            }
#pragma unroll
            for (int d0 = 0; d0 < 4; ++d0) {
                const bf16x8 k0 = *(const LAS bf16x8*)(bufp + kfrag + d0 * 32), k1 = *(const LAS bf16x8*)(bufp + kfrag + 32 * KSTR + d0 * 32);
                p0 = __builtin_amdgcn_mfma_f32_32x32x16_bf16(k0, qr[d0], p0, 0, 0, 0);
                p1 = __builtin_amdgcn_mfma_f32_32x32x16_bf16(k1, qr[d0], p1, 0, 0, 0);
            }
            __builtin_amdgcn_sched_barrier(0);
            if (SB) {
                const bool needmask = (64 * T + 63 >= qw0);
                f32x16 L0, L1;
#pragma unroll
                for (int r = 0; r < 16; ++r) {
                    { const float z = p0[r]; L0[r] = -(fmaxf(z, 0.f) + fast_log2(1.f + fast_exp2(-fabsf(z)))); }
                    { const float z = p1[r]; L1[r] = -(fmaxf(z, 0.f) + fast_log2(1.f + fast_exp2(-fabsf(z)))); } }
                if (needmask) {
#pragma unroll
                    for (int r = 0; r < 16; ++r) { const int key = 64 * T + 16 * (r >> 3) + 8 * hi + (r & 7);
                        if (key >= qabs) { L0[r] = 0.f; p0[r] = -INFINITY; } if (key + 32 >= qabs) { L1[r] = 0.f; p1[r] = -INFINITY; } } }
                float G[4], Gp[4];
                G[0] = ((L0[0] + L0[1]) + (L0[2] + L0[3])) + ((L0[4] + L0[5]) + (L0[6] + L0[7]));
                G[1] = ((L0[8] + L0[9]) + (L0[10] + L0[11])) + ((L0[12] + L0[13]) + (L0[14] + L0[15]));
                G[2] = ((L1[0] + L1[1]) + (L1[2] + L1[3])) + ((L1[4] + L1[5]) + (L1[6] + L1[7]));
                G[3] = ((L1[8] + L1[9]) + (L1[10] + L1[11])) + ((L1[12] + L1[13]) + (L1[14] + L1[15]));
#pragma unroll
                for (int j = 0; j < 4; ++j) Gp[j] = __shfl_xor(G[j], 32);
                const float pr0 = G[0] + Gp[0], pr1 = G[1] + Gp[1], pr2 = G[2] + Gp[2], pr3 = G[3] + Gp[3];
                const float t2 = pr3, t1 = t2 + pr2, t0 = t1 + pr1, total = t0 + pr0;
                float aft[4]; aft[3] = carry; aft[2] = carry + t2; aft[1] = carry + t1; aft[0] = carry + t0;
                if (hi == 0) {
#pragma unroll
                    for (int j = 0; j < 4; ++j) aft[j] += Gp[j]; }
#pragma unroll
                for (int j = 0; j < 2; ++j) { float run0 = aft[j], run1 = aft[2 + j];
#pragma unroll
                    for (int e = 7; e >= 0; --e) { const int r = 8 * j + e;
                        const float l0 = L0[r], l1 = L1[r];
                        p0[r] = fast_exp2(p0[r] + l0 + run0); run0 += l0;
                        p1[r] = fast_exp2(p1[r] + l1 + run1); run1 += l1; } }
                carry += total;
                done = __all(carry < DONE_THR) != 0;
            } else {
                float rm = fmaxf(p0[0], p1[0]);
#pragma unroll
                for (int r = 1; r < 16; ++r) rm = fmaxf(rm, fmaxf(p0[r], p1[r]));
                rm = fmaxf(rm, __shfl_xor(rm, 32));
                if (__any(rm > mrun + 8.f)) {
                    const float mn = fmaxf(mrun, rm), al = fast_exp2(mrun - mn);
                    lrun *= al;
#pragma unroll
                    for (int d = 0; d < NDB; ++d)
#pragma unroll
                        for (int r = 0; r < 16; ++r) o[d][r] *= al;
                    mrun = mn;
                }
                float ps = 0.f;
#pragma unroll
                for (int r = 0; r < 16; ++r) { p0[r] = fast_exp2(p0[r] - mrun); p1[r] = fast_exp2(p1[r] - mrun); ps += p0[r] + p1[r]; }
                lrun += ps;
            }
            __builtin_amdgcn_sched_barrier(0);
            bf16x8 pf[4];
            { u32x4 w;
              w.x = cvt_pk_bf16(p0[0], p0[1]); w.y = cvt_pk_bf16(p0[2], p0[3]); w.z = cvt_pk_bf16(p0[4], p0[5]); w.w = cvt_pk_bf16(p0[6], p0[7]); pf[0] = __builtin_bit_cast(bf16x8, w);
              w.x = cvt_pk_bf16(p0[8], p0[9]); w.y = cvt_pk_bf16(p0[10], p0[11]); w.z = cvt_pk_bf16(p0[12], p0[13]); w.w = cvt_pk_bf16(p0[14], p0[15]); pf[1] = __builtin_bit_cast(bf16x8, w);
              w.x = cvt_pk_bf16(p1[0], p1[1]); w.y = cvt_pk_bf16(p1[2], p1[3]); w.z = cvt_pk_bf16(p1[4], p1[5]); w.w = cvt_pk_bf16(p1[6], p1[7]); pf[2] = __builtin_bit_cast(bf16x8, w);
              w.x = cvt_pk_bf16(p1[8], p1[9]); w.y = cvt_pk_bf16(p1[10], p1[11]); w.z = cvt_pk_bf16(p1[12], p1[13]); w.w = cvt_pk_bf16(p1[14], p1[15]); pf[3] = __builtin_bit_cast(bf16x8, w); }
            __builtin_amdgcn_sched_barrier(0);
#pragma unroll
            for (int d = 0; d < NDB; ++d) {
#pragma unroll
                for (int ch = 0; ch < 4; ++ch) { const bf16x8 vf = *(const LAS bf16x8*)(bufp + vfrag + d * 32 * VSTR + ch * 32);
                    o[d] = __builtin_amdgcn_mfma_f32_32x32x16_bf16(vf, pf[ch], o[d], 0, 0, 0); }
                __builtin_amdgcn_sched_barrier(0); }
        }
        buf ^= 1;
    }
#undef ATT_LOAD
    bf16_t* orow = MIX + (rowbase + qabs) * DM + 128 * P;
    if (SB) {
#pragma unroll
        for (int d = 0; d < NDB; ++d)
#pragma unroll
            for (int r4 = 0; r4 < 4; ++r4) { u32x2 w; w.x = cvt_pk_bf16(o[d][4 * r4], o[d][4 * r4 + 1]); w.y = cvt_pk_bf16(o[d][4 * r4 + 2], o[d][4 * r4 + 3]);
                *(u32x2*)(orow + 64 * mu + 32 * d + 8 * r4 + 4 * hi) = w; }
        __syncthreads();
    } else {
        const float ltot = lrun + __shfl_xor(lrun, 32), inv = 1.f / ltot;
        __syncthreads();
        LAS float* ex = (LAS float*)lds + (size_t)g * 4096 + lane;
        if (mu == 1) {
#pragma unroll
            for (int d = 0; d < NDB; ++d)
#pragma unroll
                for (int r = 0; r < 16; ++r) ex[(d * 16 + r) * 64] = o[d][r] * inv; }
        __syncthreads();
        if (mu == 0) {
            float ss = 0.f;
#pragma unroll
            for (int d = 0; d < NDB; ++d) {
#pragma unroll
                for (int r = 0; r < 16; ++r) { const float v = o[d][r] * inv - lam * ex[(d * 16 + r) * 64]; o[d][r] = v; ss += v * v; }
                __builtin_amdgcn_sched_barrier(0); }
            ss += __shfl_xor(ss, 32);
            const float rs = (1.f - LAMBDA_INIT) / sqrtf(ss * (1.f / 128.f) + LN_EPS);
#pragma unroll
            for (int d = 0; d < NDB; ++d)
#pragma unroll
                for (int r4 = 0; r4 < 4; ++r4) { const int dcol = 32 * d + 8 * r4 + 4 * hi; const f32x4 gg = *(const f32x4*)(subg + dcol);
                    u32x2 w; w.x = cvt_pk_bf16(o[d][4 * r4] * rs * gg[0], o[d][4 * r4 + 1] * rs * gg[1]); w.y = cvt_pk_bf16(o[d][4 * r4 + 2] * rs * gg[2], o[d][4 * r4 + 3] * rs * gg[3]);
                    *(u32x2*)(orow + dcol) = w; }
        }
        __syncthreads();
    }
}
}

__device__ __forceinline__ void attn_phase(const int tid, const int bx, const int G, CArgs* A, LAS unsigned char* lds) {
    unsigned char* ws = A->ws; const float* subg = A->in[7];
    const bf16_t* QK = (const bf16_t*)(ws + WS_QK); const bf16_t* VT = (const bf16_t*)(ws + WS_VT); bf16_t* MIX = (bf16_t*)(ws + WS_MIX);
    const int lane = tid & 63;
    const float d1 = wave_sum(A->in[3][lane] * A->in[4][lane]), d2 = wave_sum(A->in[5][lane] * A->in[6][lane]);
    const float lam = expf(d1) - expf(d2) + LAMBDA_INIT;
    for (int v = bx; v < 256; v += G) {
        const int b = v >> 4, c = v & 15, pp = c >> 2, j = c & 3;
#pragma unroll 1
        for (int i = 0; i < 4; ++i) { const int qb = (i == 0) ? 15 - j : (i == 1) ? 8 + j : (i == 2) ? 7 - j : j;
            att::unit<false>(tid, lds, QK, VT, MIX, b, 4 + pp, qb, lam, subg); }
#pragma unroll 1
        for (int i = 0; i < 4; ++i) { const int qb = (i == 0) ? 15 - j : (i == 1) ? 8 + j : (i == 2) ? 7 - j : j;
            att::unit<true>(tid, lds, QK, VT, MIX, b, pp, qb, lam, subg); }
    }
}

constexpr int NPHASE = 15;
__global__ void __launch_bounds__(512) fwd_kernel(Args A) {
    extern __shared__ __attribute__((aligned(16))) unsigned char lds_raw[];
    LAS unsigned char* lds = (LAS unsigned char*)lds_raw;
    const int wid_s = __builtin_amdgcn_readfirstlane(threadIdx.x >> 6);
    for (int ph = A.lo; ph < A.hi; ++ph) {
        if (ph > A.lo) cg::this_grid().sync();
        CArgs* ap = (CArgs*)__builtin_amdgcn_kernarg_segment_ptr(); asm volatile("" : "+s"(ap));
        unsigned char* ws = ap->ws; float* const outp = ap->out;
        bf16_t* XB = (bf16_t*)(ws + WS_XB); bf16_t* HID = (bf16_t*)(ws + WS_HID); bf16_t* MIX = (bf16_t*)(ws + WS_MIX); bf16_t* U2 = (bf16_t*)(ws + WS_U2);
        int G = gridDim.x, bx = blockIdx.x; asm volatile("" : "+s"(G), "+s"(bx));
        unsigned ones = ~0u; asm volatile("" : "+s"(ones));
        int tid = wid_s * 64 + (int)__builtin_amdgcn_mbcnt_hi(ones, __builtin_amdgcn_mbcnt_lo(ones, 0u)); asm volatile("" : "+v"(tid));
        switch (ph) {
        case 0: prologue_phase(tid, bx, G, ap, lds); break;
        case 1: {
#pragma unroll 1
            for (int pass = 0; pass < 2; ++pass) {
                pg8::Gemm g; pg8::EpiBf16 E; pg8::StaticOrder S;
                if (pass == 0) { g = pg8::Gemm{XB, (const bf16_t*)(ws + WS_WQK), MTOK, NQK, DM}; E = pg8::EpiBf16{(bf16_t*)(ws + WS_QK), NQK}; }
                else { g = pg8::Gemm{(const bf16_t*)(ws + WS_WV), XB, DM, MTOK, DM}; E = pg8::EpiBf16{(bf16_t*)(ws + WS_VT), MTOK}; }
                S.init(g.M, g.N, G, bx);
                pg8::gemm_phase(tid, lds, g, S, E);
            } } break;
        case 2: attn_phase(tid, bx, G, ap, lds); break;
        case 3: case 6: case 10: case 13: {
            pg8::Gemm g; pg8::EpiRes E;
            if (ph == 3) { g = pg8::Gemm{MIX, (const bf16_t*)(ws + WS_WOUT), MTOK, DM, DM}; E = pg8::EpiRes{ap->in[0], outp, DM, nullptr}; }
            else if (ph == 6) { g = pg8::Gemm{HID, (const bf16_t*)(ws + WS_WD0), MTOK, DM, FF}; E = pg8::EpiRes{outp, outp, DM, nullptr}; }
            else if (ph == 10) { g = pg8::Gemm{U2, (const bf16_t*)(ws + WS_WPW2), MTOK, DM, DM}; E = pg8::EpiRes{outp, outp, DM, ap->in[15]}; }
            else { g = pg8::Gemm{HID, (const bf16_t*)(ws + WS_WD1), MTOK, DM, FF}; E = pg8::EpiRes{outp, outp, DM, nullptr}; }
            pg8::StaticOrder S; S.init(g.M, g.N, G, bx);
            pg8::gemm_phase(tid, lds, g, S, E);
        } break;
        case 4: case 7: case 11: case 14: {
            const int li = (ph == 4 || ph == 7) ? 0 : 1; const bool mix = (ph == 4 || ph == 11);
            ln_phase(tid, bx, G, outp, (mix ? ap->in[16] : ap->in[21]) + li * DM, (mix ? ap->in[17] : ap->in[22]) + li * DM, XB);
        } break;
        case 5: case 12: {
            pg8::Gemm g{XB, (const bf16_t*)(ws + (ph == 5 ? WS_WGU0 : WS_WGU1)), MTOK, 2 * FF, DM};
            pg8::EpiGated<0> E{HID, FF, nullptr, 0};
            pg8::StaticOrder S; S.init(g.M, g.N, G, bx);
            pg8::gemm_phase(tid, lds, g, S, E);
        } break;
        case 8: {
            pg8::Gemm g{XB, (const bf16_t*)(ws + WS_WPW1), MTOK, 2 * DM, DM};
            pg8::EpiGated<1> E{MIX, DM, ap->in[9], DM};
            pg8::StaticOrder S; S.init(g.M, g.N, G, bx);
            pg8::gemm_phase(tid, lds, g, S, E);
        } break;
        case 9: conv_phase(tid, bx, G, lds, MIX, U2, ap->in[10], ap->in[11], ap->in[12], ap->in[13]); break;
        default: break;
        }
    }
}

extern "C" void kernel_launch(void* const* d_in, const int* in_sizes, int n_in, void* d_out, int out_size, void* d_ws, size_t ws_size, hipStream_t stream) {
    static int grid = 0;
    if (grid == 0) {
        if (n_in != 23 || out_size != MTOK * DM || ws_size < WS_END) { fprintf(stderr, "kernel_launch: unexpected problem (n_in %d out %d ws %zu)\n", n_in, out_size, ws_size); grid = -1; return; }
        int dev = 0, cus = 0, per_cu = 0;
        hipGetDevice(&dev); hipDeviceGetAttribute(&cus, hipDeviceAttributeMultiprocessorCount, dev);
        if (hipFuncSetAttribute((const void*)fwd_kernel, hipFuncAttributeMaxDynamicSharedMemorySize, LDS_BYTES) != hipSuccess) { fprintf(stderr, "kernel_launch: hipFuncSetAttribute failed\n"); grid = -1; return; }
        if (hipOccupancyMaxActiveBlocksPerMultiprocessor(&per_cu, (const void*)fwd_kernel, 512, LDS_BYTES) != hipSuccess || per_cu < 1) { fprintf(stderr, "kernel_launch: occupancy query says %d\n", per_cu); per_cu = 1; }
        (void)hipGetLastError();
        grid = cus * 1;
        if (grid <= 0) grid = 256;
    }
    if (grid < 0) return;
    Args a{};
    for (int i = 0; i < 23; ++i) a.in[i] = (const float*)d_in[i];
    a.out = (float*)d_out; a.ws = (unsigned char*)d_ws;
#if MK_ONE_LAUNCH
    a.lo = 0; a.hi = NPHASE;
    void* args[] = {&a};
    hipError_t e = hipLaunchCooperativeKernel((const void*)fwd_kernel, dim3(grid), dim3(512), args, LDS_BYTES, stream);
    if (e != hipSuccess) fprintf(stderr, "cooperative launch failed: %s (grid %d)\n", hipGetErrorString(e), grid);
#else
    for (int ph = 0; ph < NPHASE; ++ph) { a.lo = ph; a.hi = ph + 1; hipLaunchKernelGGL(fwd_kernel, dim3(grid), dim3(512), LDS_BYTES, stream, a); }
#endif
}
```
